# Optimizing an MI355X kernel written in HIP

```python
import jax, jax.numpy as jnp
from jax import lax
import numpy as np

D_MODEL = 1024
BATCH = 2
SEQ = 8192
DEPTH = 1

CHUNK = 64
EPS = 1e-6
D_MIX = D_MODEL
D_A = D_MIX // 2
A_HEADS = 4
A_HEAD_DIM = D_A // A_HEADS
GMLP_BLOCK = 128
D_B = D_MIX - D_A
B_HEADS = 4
B_KEY_DIM = D_B // B_HEADS
B_VAL_DIM = D_B // B_HEADS
D_BK = B_HEADS * B_KEY_DIM
D_BV = B_HEADS * B_VAL_DIM
D_IN = 2 * D_A + 2 * D_BK + 2 * D_BV
N_GROUPS = 4
EXPERTS_PER_GROUP = 8
N_EXPERTS = N_GROUPS * EXPERTS_PER_GROUP
TOP_K_IN_GROUP = 2
D_EXPERT = D_MODEL // 2
MOE_BLOCK = 256

kernel_name = "hybrid_gmlp_hgrn2_hiermoe_block"


def rms_norm(x, gain):
    xf = x.astype(jnp.float32)
    y = xf * lax.rsqrt(jnp.mean(xf * xf, axis=-1, keepdims=True) + EPS)
    return (y * gain.astype(jnp.float32)).astype(x.dtype)


def gmlp_mixer(u, v, v_gain, w_s, b_s):
    bn, s, _ = u.shape
    nb = s // GMLP_BLOCK
    vh = rms_norm(v.reshape(bn, s, A_HEADS, A_HEAD_DIM), v_gain.reshape(A_HEADS, A_HEAD_DIM))
    vh = vh.reshape(bn, nb, GMLP_BLOCK, A_HEADS, A_HEAD_DIM)
    chunk_id = jnp.arange(GMLP_BLOCK) // CHUNK
    mask = chunk_id[None, :] <= chunk_id[:, None]
    w = jnp.where(mask[None], w_s, jnp.zeros_like(w_s))
    mixed = jnp.einsum('gij,bnjgc->bnigc', w, vh) + jnp.transpose(b_s)[:, :, None]
    return u * mixed.reshape(bn, s, D_A).astype(u.dtype)


def hgrn2_mixer(q_raw, f_raw, i_raw, g_raw, lb, out_gain):
    bn, s, _ = q_raw.shape
    n = s // CHUNK
    f32 = jnp.float32
    q = jax.nn.silu(q_raw.astype(f32))
    f = lb + (1.0 - lb) * jax.nn.sigmoid(f_raw.astype(f32))
    k = 1.0 - f
    lf = jnp.log(f)

    def split(t, d):
        return t.reshape(bn, n, CHUNK, B_HEADS, d).transpose(0, 3, 1, 2, 4)

    q, k, lf = split(q, B_KEY_DIM), split(k, B_KEY_DIM), split(lf, B_KEY_DIM)
    v = split(i_raw.astype(f32), B_VAL_DIM)
    b = lax.cumsum(lf, axis=3)
    ref = b[:, :, :, CHUNK // 2 - 1:CHUNK // 2, :]
    qe = q * jnp.exp(b - ref)
    ke = k * jnp.exp(ref - b)
    causal = jnp.tril(jnp.ones((CHUNK, CHUNK), dtype=bool))
    scores = jnp.einsum('bhncd,bhnsd->bhncs', qe, ke)
    scores = jnp.where(causal, scores, 0.0)
    o_intra = jnp.einsum('bhncs,bhnse->bhnce', scores, v)
    b_last = b[:, :, :, -1:, :]
    u_state = jnp.einsum('bhnsd,bhnse->bhnde', k * jnp.exp(b_last - b), v)
    decay = jnp.exp(b_last[:, :, :, 0, :])

    def step(state, xs):
        dec, upd = xs
        return dec[..., None] * state + upd, state

    s0 = jnp.zeros((bn, B_HEADS, B_KEY_DIM, B_VAL_DIM), f32)
    _, s_prev = lax.scan(step, s0, (jnp.moveaxis(decay, 2, 0), jnp.moveaxis(u_state, 2, 0)))
    s_prev = jnp.moveaxis(s_prev, 0, 2)
    o_inter = jnp.einsum('bhncd,bhnde->bhnce', q * jnp.exp(b), s_prev)
    o = (o_intra + o_inter).transpose(0, 2, 3, 1, 4).reshape(bn, s, B_HEADS, B_VAL_DIM)
    o = rms_norm(o, out_gain.reshape(B_HEADS, B_VAL_DIM))
    o = o * jax.nn.silu(g_raw.reshape(bn, s, B_HEADS, B_VAL_DIM).astype(f32))
    return o.reshape(bn, s, D_BV).astype(q_raw.dtype)


def hier_moe(xn, w_gr, b_gr, w_er, b_er, w_gate, w_up, w_down):
    bn, s, d = xn.shape
    t = bn * s
    xt = xn.reshape(t, d)
    f32 = jnp.float32
    g_logits = (xt @ w_gr).astype(f32) + b_gr.astype(f32)
    g_probs = jax.nn.softmax(g_logits, axis=-1)
    g_idx = jnp.argmax(g_logits, axis=-1)
    g_prob = jnp.take_along_axis(g_probs, g_idx[:, None], axis=1)[:, 0]
    e_logits = ((xt @ w_er).astype(f32) + b_er.astype(f32)).reshape(t, N_GROUPS, EXPERTS_PER_GROUP)
    e_logits = jnp.take_along_axis(e_logits, g_idx[:, None, None], axis=1)[:, 0]
    top_v, top_i = lax.top_k(e_logits, TOP_K_IN_GROUP)
    wts = g_prob[:, None] * jax.nn.softmax(top_v, axis=-1)
    eid = (g_idx[:, None] * EXPERTS_PER_GROUP + top_i).reshape(-1).astype(jnp.int32)
    tok = jnp.repeat(jnp.arange(t, dtype=jnp.int32), TOP_K_IN_GROUP)
    wt = wts.reshape(-1)
    n_assign = t * TOP_K_IN_GROUP

    order = jnp.argsort(eid)
    se, stok, swt = eid[order], tok[order], wt[order]
    counts = jnp.bincount(eid, length=N_EXPERTS).astype(jnp.int32)
    padded = ((counts + MOE_BLOCK - 1) // MOE_BLOCK) * MOE_BLOCK
    pend = jnp.cumsum(padded)
    pstart = pend - padded
    start = jnp.cumsum(counts) - counts
    dest = pstart[se] + (jnp.arange(n_assign, dtype=jnp.int32) - start[se])
    n_blk = -(-n_assign // MOE_BLOCK) + N_EXPERTS
    rows = n_blk * MOE_BLOCK
    buf_tok = jnp.full((rows,), t, jnp.int32).at[dest].set(stok)
    buf_wt = jnp.zeros((rows,), f32).at[dest].set(swt)
    blk_expert = jnp.clip(jnp.searchsorted(pend, jnp.arange(n_blk) * MOE_BLOCK, side='right'),
                          0, N_EXPERTS - 1)
    xpad = jnp.concatenate([xt, jnp.zeros((1, d), xt.dtype)], axis=0)

    def expert_block(args):
        tok_b, e = args
        xb = xpad[tok_b]
        h = jax.nn.silu(xb @ w_gate[e]) * (xb @ w_up[e])
        return h @ w_down[e]

    out = lax.map(expert_block, (buf_tok.reshape(n_blk, MOE_BLOCK), blk_expert))
    out = out.reshape(rows, d) * buf_wt[:, None].astype(out.dtype)
    y = jnp.zeros((t + 1, d), out.dtype).at[buf_tok].add(out)[:t]
    return y.reshape(bn, s, d).astype(xn.dtype)


def setup_inputs(seed: int = 0) -> dict:
    key = jax.random.key(seed)
    ks = jax.random.split(key, 20)
    nrm = jax.random.normal
    f32 = jnp.float32
    d = D_MODEL
    return {
        "x": nrm(ks[0], (BATCH, SEQ, d), f32),
        "norm1_gain": 1.0 + 0.05 * nrm(ks[1], (DEPTH, d), f32),
        "w_in": nrm(ks[2], (DEPTH, d, D_IN), f32) * d ** -0.5,
        "gmlp_v_gain": 1.0 + 0.05 * nrm(ks[3], (DEPTH, D_A), f32),
        "gmlp_w_s": nrm(ks[4], (DEPTH, A_HEADS, GMLP_BLOCK, GMLP_BLOCK), f32) * 0.5 * GMLP_BLOCK ** -0.5,
        "gmlp_b_s": 1.0 + 0.1 * nrm(ks[5], (DEPTH, A_HEADS, GMLP_BLOCK), f32),
        "hgrn_lower_bounds": 0.1 * nrm(ks[6], (DEPTH + 1, D_BK), f32),
        "hgrn_out_gain": 1.0 + 0.05 * nrm(ks[7], (DEPTH, D_BV), f32),
        "w_out": nrm(ks[8], (DEPTH, D_MIX, d), f32) * D_MIX ** -0.5,
        "norm2_gain": 1.0 + 0.05 * nrm(ks[9], (DEPTH, d), f32),
        "w_group_router": nrm(ks[10], (DEPTH, d, N_GROUPS), f32) * d ** -0.5,
        "b_group_router": 0.01 * nrm(ks[11], (DEPTH, N_GROUPS), f32),
        "w_expert_router": nrm(ks[12], (DEPTH, d, N_EXPERTS), f32) * d ** -0.5,
        "b_expert_router": 0.01 * nrm(ks[13], (DEPTH, N_EXPERTS), f32),
        "w_gate": nrm(ks[14], (DEPTH, N_EXPERTS, d, D_EXPERT), f32) * d ** -0.5,
        "w_up": nrm(ks[15], (DEPTH, N_EXPERTS, d, D_EXPERT), f32) * d ** -0.5,
        "w_down": nrm(ks[16], (DEPTH, N_EXPERTS, D_EXPERT, d), f32) * D_EXPERT ** -0.5,
        "final_gain": 1.0 + 0.05 * nrm(ks[17], (d,), f32),
    }


def reference(x, norm1_gain, w_in, gmlp_v_gain, gmlp_w_s, gmlp_b_s, hgrn_lower_bounds,
              hgrn_out_gain, w_out, norm2_gain, w_group_router, b_group_router,
              w_expert_router, b_expert_router, w_gate, w_up, w_down, final_gain):
    lb_all = jnp.cumsum(jax.nn.softmax(hgrn_lower_bounds.astype(jnp.float32), axis=0), axis=0)
    split_at = [D_A, 2 * D_A, 2 * D_A + D_BK, 2 * D_A + 2 * D_BK, 2 * D_A + 2 * D_BK + D_BV]
    h = x
    for l in range(DEPTH):
        n1 = rms_norm(h, norm1_gain[l])
        proj = n1 @ w_in[l]
        u, v, q, f, i, g = jnp.split(proj, split_at, axis=-1)
        a_out = gmlp_mixer(jax.nn.gelu(u, approximate=False), jax.nn.gelu(v, approximate=False),
                           gmlp_v_gain[l], gmlp_w_s[l], gmlp_b_s[l])
        b_out = hgrn2_mixer(q, f, i, g, lb_all[l], hgrn_out_gain[l])
        h = h + jnp.concatenate([a_out, b_out], axis=-1) @ w_out[l]
        n2 = rms_norm(h, norm2_gain[l])
        h = h + hier_moe(n2, w_group_router[l], b_group_router[l], w_expert_router[l],
                         b_expert_router[l], w_gate[l], w_up[l], w_down[l])
    return rms_norm(h, final_gain)
```

```cpp
#include <hip/hip_runtime.h>
#include <cstdio>
#include <cstdint>

#ifndef MK_ONE
#define MK_ONE 0
#endif

#define LAS __attribute__((address_space(3)))
typedef unsigned short u16;
typedef short bf16x8 __attribute__((ext_vector_type(8)));
typedef float f32x4 __attribute__((ext_vector_type(4)));
typedef float f32x2 __attribute__((ext_vector_type(2)));
typedef unsigned u32x4 __attribute__((ext_vector_type(4)));
typedef unsigned u32x2 __attribute__((ext_vector_type(2)));
typedef _Float16 h16x2 __attribute__((ext_vector_type(2)));

constexpr int T = 16384, D = 1024, DIN = 3072;
constexpr int CU_ = 0, CV_ = 512, CQ_ = 1024, CF_ = 1536, CI_ = 2048, CG_ = 2560;
constexpr float EPS = 1e-6f;
constexpr int NE = 32, DE = 512;
constexpr int MAXROWS = 32768 + 32 * 256;
constexpr int NPH = 11;

constexpr size_t MiB = 1u << 20;
constexpr size_t WS_CTL = 0, CTL_BYTES = 1 * MiB;
constexpr size_t WS_WIN = 1 * MiB, WS_WOUT = 7 * MiB, WS_WRT = 9 * MiB;
constexpr size_t WS_LB = 9 * MiB + 128 * 1024;
constexpr size_t WS_RSTD2 = 10 * MiB;
constexpr size_t WS_RTE = 10 * MiB + 64 * 1024;
constexpr size_t WS_RTW = WS_RTE + 128 * 1024;
constexpr size_t WS_RTR = WS_RTW + 128 * 1024;
constexpr size_t WS_CNT = WS_RTR + 128 * 1024;
constexpr size_t WS_ROWTOK = WS_CNT + 32 * 1024;
constexpr size_t WS_ROWWT = WS_ROWTOK + 160 * 1024;
constexpr size_t WS_META = WS_ROWWT + 160 * 1024;
constexpr size_t WS_DEC = 12 * MiB;
constexpr size_t WS_PROJ = 16 * MiB;
constexpr size_t WS_WGU = 16 * MiB, WS_WD = 80 * MiB;
constexpr size_t WS_XB = 112 * MiB, WS_MIX = 112 * MiB, WS_Y0 = 112 * MiB;
constexpr size_t WS_UT = 144 * MiB;
constexpr size_t WS_HB = 144 * MiB, WS_HID = 176 * MiB;
constexpr size_t WS_SP = 208 * MiB;
constexpr size_t WS_Y1 = 216 * MiB;
constexpr size_t WS_END = 248 * MiB;

constexpr int LDS_BYTES = 147456;

__device__ __forceinline__ float bf2f(unsigned b) { return __uint_as_float(b << 16); }
__device__ __forceinline__ float bflo(unsigned w) { return __uint_as_float(w << 16); }
__device__ __forceinline__ float bfhi(unsigned w) { return __uint_as_float(w & 0xffff0000u); }
__device__ __forceinline__ unsigned pk2(float lo, float hi) { unsigned r; asm volatile("v_cvt_pk_bf16_f32 %0, %1, %2" : "=v"(r) : "v"(lo), "v"(hi)); return r; }
__device__ __forceinline__ unsigned pkh2(float lo, float hi) { h16x2 v; v.x = (_Float16)lo; v.y = (_Float16)hi; return __builtin_bit_cast(unsigned, v); }
__device__ __forceinline__ float hlo(unsigned w) { h16x2 v = __builtin_bit_cast(h16x2, w); return (float)v.x; }
__device__ __forceinline__ float hhi(unsigned w) { h16x2 v = __builtin_bit_cast(h16x2, w); return (float)v.y; }
__device__ __forceinline__ float fast_exp(float x) { return __expf(x); }
__device__ __forceinline__ float silu_f(float z) { return z * __builtin_amdgcn_rcpf(1.0f + __expf(-z)); }
__device__ __forceinline__ f32x2 gelu_pk(f32x2 v) {
    const f32x2 av = __builtin_elementwise_abs(v), d = av * 0.2316418882f + 1.0f;
    f32x2 t; t.x = __builtin_amdgcn_rcpf(d.x); t.y = __builtin_amdgcn_rcpf(d.y);
    f32x2 q = t * 0.5307027145f + (-0.7265760135f); q = q * t + 0.7107068705f; q = q * t + (-0.142248368f); q = q * t + 0.127414796f; q = q * t;
    const f32x2 s = (v * v) * (-0.72134752044f);
    f32x2 e; e.x = __builtin_amdgcn_exp2f(s.x); e.y = __builtin_amdgcn_exp2f(s.y);
    const f32x2 m = v * (q * e), r = v - m;
    f32x2 o; o.x = v.x < 0.f ? m.x : r.x; o.y = v.y < 0.f ? m.y : r.y; return o;
}
__device__ __forceinline__ float wave_sum(float v) {
#pragma unroll
    for (int o = 1; o < 64; o <<= 1) v += __shfl_xor(v, o);
    return v;
}
__device__ __forceinline__ int perm32(int rho) { const int n = rho >> 4, i = rho & 15; return 8 * (i >> 2) + 4 * n + (i & 3); }
#define LDS_WAIT() asm volatile("s_waitcnt lgkmcnt(0)" ::: "memory")

#define XB_TMO      128
#define XB_XCNT(j)  (256  + 64 * (j))
#define XB_XSUB(j)  (1280 + 64 * (j))
#define XB_XGEN(j)  (2304 + 64 * (j))
#define XB_TOP      3328
#define XB_TOPGEN   3392
#define XCD_BAR_WORDS 3456
#define XB_SPIN_CAP (1u << 18)
__device__ __forceinline__ unsigned xb_ld(unsigned* p)              { return __hip_atomic_load(p, __ATOMIC_RELAXED, __HIP_MEMORY_SCOPE_AGENT); }
__device__ __forceinline__ unsigned xb_add(unsigned* p, unsigned v) { return __hip_atomic_fetch_add(p, v, __ATOMIC_RELAXED, __HIP_MEMORY_SCOPE_AGENT); }
__device__ __forceinline__ unsigned xb_xcc_id() { return (unsigned)__builtin_amdgcn_s_getreg((3 << 11) | 20) & 0xFu; }
#define XB_SPIN(cond, bar) do { unsigned _sp = 0; while (cond) { __builtin_amdgcn_s_sleep(1); \
    if ((++_sp & 255u) == 0u) { if (xb_ld(&(bar)[XB_TMO])) break; if (_sp > XB_SPIN_CAP) { atomicAdd(&(bar)[XB_TMO], 1u); break; } } } } while (0)
struct XcdBarrier { unsigned* bar; unsigned x; volatile LAS unsigned* st; };
__device__ __forceinline__ XcdBarrier xcd_barrier_post(unsigned* bar, volatile LAS unsigned* st) {
    XcdBarrier b; b.bar = bar; b.x = xb_xcc_id(); b.st = st;
    if (threadIdx.x == 0) (void)xb_add(&bar[XB_XCNT(b.x)], 1u);
    return b;
}
__device__ __forceinline__ void xcd_barrier_complete(unsigned* bar, unsigned x, unsigned& nloc, unsigned& nx) {
    const unsigned G = gridDim.x * gridDim.y * gridDim.z;
    unsigned sum, cnt, mine, sp = 0u;
    for (;;) {
        sum = 0u; cnt = 0u; mine = 0u;
#pragma unroll
        for (unsigned j = 0; j < 16; ++j) { const unsigned c = xb_ld(&bar[XB_XCNT(j)]); sum += c; cnt += (c > 0u) ? 1u : 0u; mine = (j == x) ? c : mine; }
        if (sum == G) break;
        __builtin_amdgcn_s_sleep(1);
        if ((++sp & 255u) == 0u) { if (xb_ld(&bar[XB_TMO])) break; if (sp > XB_SPIN_CAP) { atomicAdd(&bar[XB_TMO], 1u); break; } }
    }
    nloc = mine > 0u ? mine : 1u; nx = cnt > 0u ? cnt : 1u;
}
__device__ __forceinline__ void xcd_barrier(const XcdBarrier& b) {
    asm volatile("s_waitcnt vmcnt(0)" ::: "memory");
    __syncthreads();
    if (threadIdx.x == 0) {
        unsigned* bar = b.bar;
        __builtin_amdgcn_s_waitcnt(0);
        unsigned nloc = b.st[0], nx = b.st[1];
        if (nloc == 0u) { xcd_barrier_complete(bar, b.x, nloc, nx); b.st[0] = nloc; b.st[1] = nx; }
        const unsigned old = xb_add(&bar[XB_XSUB(b.x)], 1u);
        const unsigned gen = old / nloc;
        if (old + 1u == (gen + 1u) * nloc) {
            __builtin_amdgcn_fence(__ATOMIC_RELEASE, "agent");
            asm volatile("s_waitcnt vmcnt(0)" ::: "memory");
            const unsigned og = xb_add(&bar[XB_TOP], 1u);
            const unsigned tg = og / nx;
            if (og + 1u == (tg + 1u) * nx) xb_add(&bar[XB_TOPGEN], 1u);
            else XB_SPIN(xb_ld(&bar[XB_TOPGEN]) == tg, bar);
            __builtin_amdgcn_fence(__ATOMIC_ACQUIRE, "agent");
            xb_add(&bar[XB_XGEN(b.x)], 1u);
            asm volatile("s_waitcnt vmcnt(0)" ::: "memory");
        } else {
            XB_SPIN(xb_ld(&bar[XB_XGEN(b.x)]) == gen, bar);
            __builtin_amdgcn_fence(__ATOMIC_ACQUIRE, "agent");
            asm volatile("s_waitcnt vmcnt(0)" ::: "memory");
        }
    }
    __syncthreads();
}

struct Args { const float* in[18]; float* out; unsigned char* ws; int ph_lo, ph_hi; };
enum { I_X = 0, I_G1, I_WIN, I_VG, I_WS, I_BS, I_LB, I_OG, I_WOUT, I_G2, I_WGR, I_BGR, I_WER, I_BER, I_WG, I_WU, I_WDN, I_FG };

struct Unit { int pm, pn; };
struct StaticOrder {
    int nM, nN, nwg, G, c;
    __device__ void init(int M, int N, int G_, int c_) { nM = M / 256; nN = N / 256; nwg = nM * nN; G = G_; c = c_; }
    __device__ bool next(int i, Unit& u) const {
        const long L = (long)i * G + c; if (L >= nwg) return false;
        int wgid = (int)L; { const int q = nwg / 8, r = nwg % 8, xcd = wgid % 8, off = wgid / 8; wgid = (xcd < r ? xcd * (q + 1) : r * (q + 1) + (xcd - r) * q) + off; }
        const int nig = 8 * nN, gid = wgid / nig, fm = gid * 8, gsz = (nM - fm) < 8 ? (nM - fm) : 8;
        u.pm = fm + ((wgid % nig) % gsz); u.pn = (wgid % nig) / gsz; return true;
    }
};

constexpr int SG_LD = 144;
template <class Epi, class U>
__device__ __forceinline__ void sg_unit(unsigned char* lds, const u16* (&ap)[4], const u16* (&bp)[4], int K, const Epi& E, const U& u) {
    const int tid = threadIdx.x, wid = __builtin_amdgcn_readfirstlane(tid >> 6), lane = tid & 63, wr = wid >> 2, wc = wid & 3, fr = lane & 15, fq = lane >> 4;
    unsigned char* As = lds; unsigned char* Bs = lds + 256 * SG_LD;
    f32x4 acc[2][2][4][2];
#pragma unroll
    for (int a = 0; a < 2; ++a)
#pragma unroll
        for (int b = 0; b < 2; ++b)
#pragma unroll
            for (int m = 0; m < 4; ++m)
#pragma unroll
                for (int n = 0; n < 2; ++n) acc[a][b][m][n] = (f32x4){0.f, 0.f, 0.f, 0.f};
    u32x4 ra[4], rb[4];
#pragma unroll
    for (int i = 0; i < 4; ++i) { ra[i] = *(const u32x4*)(ap[i]); rb[i] = *(const u32x4*)(bp[i]); }
    const int nk = K / 64;
    const int wrow = (tid >> 3), wch = (tid & 7) * 16;
    for (int kt = 0; kt < nk; ++kt) {
#pragma unroll
        for (int i = 0; i < 4; ++i) { *(u32x4*)(As + (wrow + 64 * i) * SG_LD + wch) = ra[i]; *(u32x4*)(Bs + (wrow + 64 * i) * SG_LD + wch) = rb[i]; }
        __syncthreads();
        if (kt + 1 < nk) {
#pragma unroll
            for (int i = 0; i < 4; ++i) { ra[i] = *(const u32x4*)(ap[i] + (kt + 1) * 64); rb[i] = *(const u32x4*)(bp[i] + (kt + 1) * 64); }
        }
        bf16x8 Bf[2][2][2];
#pragma unroll
        for (int bj = 0; bj < 2; ++bj)
#pragma unroll
            for (int n = 0; n < 2; ++n)
#pragma unroll
                for (int k = 0; k < 2; ++k) Bf[bj][n][k] = *(const bf16x8*)(Bs + (128 * bj + 32 * wc + 16 * n + fr) * SG_LD + (32 * k + 8 * fq) * 2);
#pragma unroll
        for (int ai = 0; ai < 2; ++ai) {
            bf16x8 Af[4][2];
#pragma unroll
            for (int m = 0; m < 4; ++m)
#pragma unroll
                for (int k = 0; k < 2; ++k) Af[m][k] = *(const bf16x8*)(As + (128 * ai + 64 * wr + 16 * m + fr) * SG_LD + (32 * k + 8 * fq) * 2);
#pragma unroll
            for (int bj = 0; bj < 2; ++bj)
#pragma unroll
                for (int m = 0; m < 4; ++m)
#pragma unroll
                    for (int n = 0; n < 2; ++n)
#pragma unroll
                        for (int k = 0; k < 2; ++k) acc[ai][bj][m][n] = __builtin_amdgcn_mfma_f32_16x16x32_bf16(Bf[bj][n][k], Af[m][k], acc[ai][bj][m][n], 0, 0, 0);
        }
        __syncthreads();
    }
    E(acc, u, wr, wc, fr, fq);
}
template <class Epi>
__device__ __forceinline__ void dense_gemm_phase(unsigned char* lds, const u16* A, const u16* Bt, int M, int N, int K, const Epi& E) {
    StaticOrder S; S.init(M, N, (int)gridDim.x, (int)blockIdx.x);
    Unit u; const int tid = threadIdx.x;
    for (int i = 0; S.next(i, u); ++i) {
        const u16* ap[4]; const u16* bp[4];
#pragma unroll
        for (int j = 0; j < 4; ++j) { const int r = (tid >> 3) + 64 * j; const int rb = Epi::PERM ? ((r & ~31) + perm32(r & 31)) : r;
            ap[j] = A + (size_t)(u.pm * 256 + r) * K + (tid & 7) * 8; bp[j] = Bt + (size_t)(u.pn * 256 + rb) * K + (tid & 7) * 8; }
        sg_unit(lds, ap, bp, K, E, u);
    }
}

struct EpiProj {
    static constexpr bool PERM = true;
    u16* P; const float* lb;
    __device__ __forceinline__ void operator()(const f32x4 (&acc)[2][2][4][2], const Unit& u, int wr, int wc, int fr, int fq) const {
        const int type = u.pn >> 1;
        const int row0 = u.pm * 256 + wr * 64 + fr, col0 = u.pn * 256 + wc * 32 + 8 * fq;
        f32x4 lbv[2][2];
#pragma unroll
        for (int bj = 0; bj < 2; ++bj)
#pragma unroll
            for (int n = 0; n < 2; ++n) lbv[bj][n] = (type == 3) ? *(const f32x4*)(lb + (col0 - CF_) + bj * 128 + 4 * n) : (f32x4){0.f, 0.f, 0.f, 0.f};
#pragma unroll
        for (int ai = 0; ai < 2; ++ai)
#pragma unroll
            for (int m = 0; m < 4; ++m) { u16* rowp = P + (size_t)(row0 + ai * 128 + m * 16) * DIN + col0;
#pragma unroll
                for (int bj = 0; bj < 2; ++bj) { f32x4 v0 = acc[ai][bj][m][0], v1 = acc[ai][bj][m][1]; u32x4 w;
                    if (type <= 1) { f32x2 a = gelu_pk((f32x2){v0[0], v0[1]}), b = gelu_pk((f32x2){v0[2], v0[3]}), c = gelu_pk((f32x2){v1[0], v1[1]}), d = gelu_pk((f32x2){v1[2], v1[3]});
                        w.x = pk2(a.x, a.y); w.y = pk2(b.x, b.y); w.z = pk2(c.x, c.y); w.w = pk2(d.x, d.y); }
                    else if (type == 2 || type == 5) {
                        w.x = pk2(silu_f(v0[0]), silu_f(v0[1])); w.y = pk2(silu_f(v0[2]), silu_f(v0[3])); w.z = pk2(silu_f(v1[0]), silu_f(v1[1])); w.w = pk2(silu_f(v1[2]), silu_f(v1[3])); }
                    else if (type == 3) { float l[8];
#pragma unroll
                        for (int j = 0; j < 4; ++j) { const float b0 = lbv[bj][0][j], b1 = lbv[bj][1][j];
                            l[j] = __logf(b0 + (1.f - b0) * __builtin_amdgcn_rcpf(1.f + __expf(-v0[j])));
                            l[4 + j] = __logf(b1 + (1.f - b1) * __builtin_amdgcn_rcpf(1.f + __expf(-v1[j]))); }
                        w.x = pkh2(l[0], l[1]); w.y = pkh2(l[2], l[3]); w.z = pkh2(l[4], l[5]); w.w = pkh2(l[6], l[7]); }
                    else { w.x = pk2(v0[0], v0[1]); w.y = pk2(v0[2], v0[3]); w.z = pk2(v1[0], v1[1]); w.w = pk2(v1[2], v1[3]); }
                    *(u32x4*)(rowp + bj * 128) = w; } }
    }
};
struct EpiRes {
    static constexpr bool PERM = false;
    const float* x; float* H; u16* HB;
    __device__ __forceinline__ void operator()(const f32x4 (&acc)[2][2][4][2], const Unit& u, int wr, int wc, int fr, int fq) const {
        const int row0 = u.pm * 256 + wr * 64 + fr, col0 = u.pn * 256 + wc * 32 + 4 * fq;
#pragma unroll
        for (int ai = 0; ai < 2; ++ai)
#pragma unroll
            for (int m = 0; m < 4; ++m) { const size_t off = (size_t)(row0 + ai * 128 + m * 16) * D + col0;
#pragma unroll
                for (int bj = 0; bj < 2; ++bj)
#pragma unroll
                    for (int n = 0; n < 2; ++n) { const size_t o = off + bj * 128 + n * 16; const f32x4 h = *(const f32x4*)(x + o) + acc[ai][bj][m][n];
                        *(f32x4*)(H + o) = h; u32x2 w; w.x = pk2(h[0], h[1]); w.y = pk2(h[2], h[3]); *(u32x2*)(HB + o) = w; } }
    }
};
struct MUnit { int ti, pn, e, nv; };
struct EpiGU {
    static constexpr bool PERM = true;
    u16* HID; const int* rowtok; const float* rstd2;
    __device__ __forceinline__ void operator()(const f32x4 (&acc)[2][2][4][2], const MUnit& u, int wr, int wc, int fr, int fq) const {
        const int r0 = wr * 64 + fr, col0 = u.pn * 128 + wc * 32 + 8 * fq;
#pragma unroll
        for (int ai = 0; ai < 2; ++ai)
#pragma unroll
            for (int m = 0; m < 4; ++m) { const int r = r0 + ai * 128 + m * 16; const bool valid = r < u.nv; const int pos = u.ti * 256 + r;
                const int tk = valid ? rowtok[pos] : 0; const float rs = rstd2[tk >> 1];
                const f32x4 g0 = acc[ai][0][m][0] * rs, g1 = acc[ai][0][m][1] * rs, u0 = acc[ai][1][m][0] * rs, u1 = acc[ai][1][m][1] * rs;
                u32x4 w; w.x = pk2(silu_f(g0[0]) * u0[0], silu_f(g0[1]) * u0[1]); w.y = pk2(silu_f(g0[2]) * u0[2], silu_f(g0[3]) * u0[3]);
                w.z = pk2(silu_f(g1[0]) * u1[0], silu_f(g1[1]) * u1[1]); w.w = pk2(silu_f(g1[2]) * u1[2], silu_f(g1[3]) * u1[3]);
                if (valid) *(u32x4*)(HID + (size_t)pos * DE + col0) = w; }
    }
};
struct EpiDown {
    static constexpr bool PERM = true;
    u16* Y0; long y1off; const int* rowtok; const float* rowwt;
    __device__ __forceinline__ void operator()(const f32x4 (&acc)[2][2][4][2], const MUnit& u, int wr, int wc, int fr, int fq) const {
        const int r0 = wr * 64 + fr, col0 = u.pn * 256 + wc * 32 + 8 * fq;
#pragma unroll
        for (int ai = 0; ai < 2; ++ai)
#pragma unroll
            for (int m = 0; m < 4; ++m) { const int r = r0 + ai * 128 + m * 16; const bool valid = r < u.nv; const int pos = u.ti * 256 + r;
                if (valid) { const int tk = rowtok[pos]; const float wt = rowwt[pos]; u16* yp = Y0 + (long)(tk & 1) * y1off + (size_t)(tk >> 1) * D + col0;
#pragma unroll
                    for (int bj = 0; bj < 2; ++bj) { const f32x4 v0 = acc[ai][bj][m][0] * wt, v1 = acc[ai][bj][m][1] * wt; u32x4 w;
                        w.x = pk2(v0[0], v0[1]); w.y = pk2(v0[2], v0[3]); w.z = pk2(v1[0], v1[1]); w.w = pk2(v1[2], v1[3]); *(u32x4*)(yp + bj * 128) = w; } } }
    }
};

__device__ __forceinline__ void tr_item(const float* W, int N, int k0, int n0, const float* gain, u16* WT, int ldT, int drow0, float* scr, int lane) {
#pragma unroll 8
    for (int i = 0; i < 32; ++i) { const int kk = 2 * i + (lane >> 5); float v = W[(size_t)(k0 + kk) * N + n0 + (lane & 31)]; if (gain) v *= gain[k0 + kk]; scr[kk * 33 + (lane & 31)] = v; }
    LDS_WAIT();
    const int c = lane & 7;
#pragma unroll
    for (int j = 0; j < 4; ++j) { const int n = (lane >> 3) + 8 * j; const float* s = scr + (8 * c) * 33 + n;
        u32x4 o; o.x = pk2(s[0 * 33], s[1 * 33]); o.y = pk2(s[2 * 33], s[3 * 33]); o.z = pk2(s[4 * 33], s[5 * 33]); o.w = pk2(s[6 * 33], s[7 * 33]);
        *(u32x4*)(WT + (size_t)(drow0 + n) * ldT + k0 + 8 * c) = o; }
    LDS_WAIT();
}
__device__ __forceinline__ void p0_prologue(const Args& a, unsigned char* lds) {
    const int tid = threadIdx.x, lane = tid & 63, wave = tid >> 6;
    float* scr = (float*)(lds + wave * 16384);
    const int gw = blockIdx.x * 8 + wave, NGW = gridDim.x * 8;
    u16* WIN = (u16*)(a.ws + WS_WIN); u16* WOUT = (u16*)(a.ws + WS_WOUT);
    constexpr int I_IN = 16 * 96, I_OUT = 16 * 32;
    for (int it = gw; it < I_IN + I_OUT; it += NGW) {
        if (it < I_IN) { const int kb = it / 96, nb = it % 96; tr_item(a.in[I_WIN], DIN, 64 * kb, 32 * nb, a.in[I_G1], WIN, D, 32 * nb, scr, lane); }
        else { const int r = it - I_IN, kb = r / 32, nb = r % 32; tr_item(a.in[I_WOUT], D, 64 * kb, 32 * nb, nullptr, WOUT, D, 32 * nb, scr, lane); }
    }
    const float* x = a.in[I_X]; u16* XB = (u16*)(a.ws + WS_XB);
    for (int m = gw; m < T; m += NGW) {
        const f32x4* xr = (const f32x4*)(x + (size_t)m * D) + lane; f32x4 v[4]; float s = 0.f;
#pragma unroll
        for (int j = 0; j < 4; ++j) { v[j] = xr[64 * j]; s += (v[j].x * v[j].x + v[j].y * v[j].y) + (v[j].z * v[j].z + v[j].w * v[j].w); }
        const float rstd = 1.0f / sqrtf(wave_sum(s) * (1.f / D) + EPS);
        u32x2* o8 = (u32x2*)(XB + (size_t)m * D) + lane;
#pragma unroll
        for (int j = 0; j < 4; ++j) { u32x2 w; w.x = pk2(v[j].x * rstd, v[j].y * rstd); w.y = pk2(v[j].z * rstd, v[j].w * rstd); o8[64 * j] = w; }
    }
    u16* WRT = (u16*)(a.ws + WS_WRT); const float* g2 = a.in[I_G2];
    for (int idx = blockIdx.x * 512 + tid; idx < 48 * 128; idx += gridDim.x * 512) { const int o = idx >> 7, kc = idx & 127; float v[8];
#pragma unroll
        for (int j = 0; j < 8; ++j) { const int k = 8 * kc + j; v[j] = o < 32 ? a.in[I_WER][k * 32 + o] * g2[k] : (o < 36 ? a.in[I_WGR][k * 4 + (o - 32)] * g2[k] : 0.f); }
        u32x4 w; w.x = pk2(v[0], v[1]); w.y = pk2(v[2], v[3]); w.z = pk2(v[4], v[5]); w.w = pk2(v[6], v[7]); *(u32x4*)(WRT + (size_t)o * D + 8 * kc) = w; }
    if (blockIdx.x == 0) { float* LB = (float*)(a.ws + WS_LB); const float* h = a.in[I_LB]; if (tid < 512) LB[tid] = 1.0f / (1.0f + expf(h[512 + tid] - h[tid])); }
}

__device__ __forceinline__ void gmlp_unit(const Args& a, unsigned char* lds, int unit) {
    const int tid = threadIdx.x, wid = __builtin_amdgcn_readfirstlane(tid >> 6), lane = tid & 63, fr = lane & 15, fq = lane >> 4;
    const int g = unit & 3, t0 = (unit >> 2) * 128;
    const u16* PROJ = (const u16*)(a.ws + WS_PROJ); u16* MIX = (u16*)(a.ws + WS_MIX);
    unsigned char* BT = lds;
    float* SSP = (float*)(lds + 34816);
    float* RS = (float*)(lds + 34816 + 8704);
    { const int jq = tid & 31, cc = tid >> 5; u32x4 rv[4];
#pragma unroll
      for (int r = 0; r < 4; ++r) { rv[r] = *(const u32x4*)(PROJ + (size_t)(t0 + 4 * jq + r) * DIN + CV_ + g * 128 + 8 * cc);
          float s = 0.f;
#pragma unroll
          for (int w = 0; w < 4; ++w) { const float lo = bflo(rv[r][w]), hi = bfhi(rv[r][w]); s += lo * lo + hi * hi; }
          SSP[(4 * jq + r) * 17 + cc] = s; }
#pragma unroll
      for (int e = 0; e < 8; ++e) { const int w = e >> 1, sh = (e & 1) * 16;
          u32x2 o; o.x = ((rv[0][w] >> sh) & 0xffffu) | (((rv[1][w] >> sh) & 0xffffu) << 16); o.y = ((rv[2][w] >> sh) & 0xffffu) | (((rv[3][w] >> sh) & 0xffffu) << 16);
          *(u32x2*)(BT + (8 * cc + e) * 272 + 8 * jq) = o; } }
    __syncthreads();
    if (tid < 128) { float s = 0.f;
#pragma unroll
        for (int c = 0; c < 16; ++c) s += SSP[tid * 17 + c];
        RS[tid] = 1.0f / sqrtf(s * (1.f / 128.f) + EPS); }
    __syncthreads();
    const int i = 16 * wid + fr;
    bf16x8 Af[4];
#pragma unroll
    for (int ks = 0; ks < 4; ++ks) { const int j0 = 32 * ks + 8 * fq; const float* wp = a.in[I_WS] + (size_t)(g * 128 + i) * 128 + j0;
        f32x4 w0 = *(const f32x4*)wp, w1 = *(const f32x4*)(wp + 4); const f32x4 r0 = *(const f32x4*)(RS + j0), r1 = *(const f32x4*)(RS + j0 + 4);
        const bool keep = (i >= 64) || (j0 < 64); w0 = keep ? w0 * r0 : (f32x4){0.f, 0.f, 0.f, 0.f}; w1 = keep ? w1 * r1 : (f32x4){0.f, 0.f, 0.f, 0.f};
        u32x4 p; p.x = pk2(w0[0], w0[1]); p.y = pk2(w0[2], w0[3]); p.z = pk2(w1[0], w1[1]); p.w = pk2(w1[2], w1[3]); Af[ks] = __builtin_bit_cast(bf16x8, p); }
    const float bias = a.in[I_BS][g * 128 + i];
#pragma unroll
    for (int nb = 0; nb < 8; ++nb) { f32x4 acc = (f32x4){0.f, 0.f, 0.f, 0.f};
#pragma unroll
        for (int ks = 0; ks < 4; ++ks) { const bf16x8 Bf = *(const bf16x8*)(BT + (16 * nb + fr) * 272 + (32 * ks + 8 * fq) * 2);
            acc = __builtin_amdgcn_mfma_f32_16x16x32_bf16(Bf, Af[ks], acc, 0, 0, 0); }
        const int c0 = 16 * nb + 4 * fq;
        const u32x2 uu = *(const u32x2*)(PROJ + (size_t)(t0 + i) * DIN + CU_ + g * 128 + c0);
        const f32x4 gn = *(const f32x4*)(a.in[I_VG] + g * 128 + c0);
        const float o0 = bflo(uu.x) * (gn[0] * acc[0] + bias), o1 = bfhi(uu.x) * (gn[1] * acc[1] + bias), o2 = bflo(uu.y) * (gn[2] * acc[2] + bias), o3 = bfhi(uu.y) * (gn[3] * acc[3] + bias);
        u32x2 w; w.x = pk2(o0, o1); w.y = pk2(o2, o3); *(u32x2*)(MIX + (size_t)(t0 + i) * D + g * 128 + c0) = w; }
    __syncthreads();
}

__device__ __forceinline__ void hgrn_load_lf_v(const u16* PROJ, int t0, int h, float* LF, unsigned char* VT, int tid) {
#pragma unroll
    for (int i = 0; i < 2; ++i) { const int p = tid + 512 * i, s = p >> 4, dc = p & 15;
        const u32x4 raw = *(const u32x4*)(PROJ + (size_t)(t0 + s) * DIN + CF_ + h * 128 + 8 * dc);
        f32x4 a, b; a[0] = hlo(raw.x); a[1] = hhi(raw.x); a[2] = hlo(raw.y); a[3] = hhi(raw.y); b[0] = hlo(raw.z); b[1] = hhi(raw.z); b[2] = hlo(raw.w); b[3] = hhi(raw.w);
        *(f32x4*)(LF + s * 128 + 8 * dc) = a; *(f32x4*)(LF + s * 128 + 8 * dc + 4) = b; }
    { const int sq = tid & 31, ec = tid >> 5;
      const u32x4 v0 = *(const u32x4*)(PROJ + (size_t)(t0 + 2 * sq) * DIN + CI_ + h * 128 + 8 * ec), v1 = *(const u32x4*)(PROJ + (size_t)(t0 + 2 * sq + 1) * DIN + CI_ + h * 128 + 8 * ec);
#pragma unroll
      for (int e = 0; e < 8; ++e) { const int w = e >> 1, sh = (e & 1) * 16;
          *(unsigned*)(VT + (8 * ec + e) * 144 + 4 * sq) = ((v0[w] >> sh) & 0xffffu) | (((v1[w] >> sh) & 0xffffu) << 16); } }
}

__device__ __forceinline__ void hgrn_local_unit(const Args& a, unsigned char* lds, int un) {
    const int tid = threadIdx.x, wid = __builtin_amdgcn_readfirstlane(tid >> 6), lane = tid & 63, fr = lane & 15, fq = lane >> 4;
    const int n = un & 127, bh = un >> 7, h = bh & 3, b = bh >> 2, t0 = b * 8192 + n * 64;
    const u16* PROJ = (const u16*)(a.ws + WS_PROJ);
    float* LF = (float*)lds; float* GT = (float*)(lds + 32768); unsigned char* KT = lds + 34816; unsigned char* VT = lds + 53248;
    hgrn_load_lf_v(PROJ, t0, h, LF, VT, tid);
    __syncthreads();
    const int d = tid & 127, sg = tid >> 7;
    float lfv[16], cum[16]; float run = 0.f;
#pragma unroll
    for (int r = 0; r < 16; ++r) { lfv[r] = LF[(16 * sg + r) * 128 + d]; run += lfv[r]; cum[r] = run; }
    GT[sg * 128 + d] = run;
    __syncthreads();
    float off = 0.f, tot = 0.f;
#pragma unroll
    for (int q = 0; q < 4; ++q) { const float gq = GT[q * 128 + d]; tot += gq; if (q < sg) off += gq; }
    { u32x4 w0, w1; float kl[16];
#pragma unroll
      for (int r = 0; r < 16; ++r) kl[r] = (1.0f - __expf(lfv[r])) * __expf(tot - (off + cum[r]));
      w0.x = pk2(kl[0], kl[1]); w0.y = pk2(kl[2], kl[3]); w0.z = pk2(kl[4], kl[5]); w0.w = pk2(kl[6], kl[7]);
      w1.x = pk2(kl[8], kl[9]); w1.y = pk2(kl[10], kl[11]); w1.z = pk2(kl[12], kl[13]); w1.w = pk2(kl[14], kl[15]);
      *(u32x4*)(KT + d * 144 + 32 * sg) = w0; *(u32x4*)(KT + d * 144 + 32 * sg + 16) = w1; }
    if (sg == 0) ((float*)(a.ws + WS_DEC))[(size_t)un * 128 + d] = __expf(tot);
    __syncthreads();
    bf16x8 Kf[2];
#pragma unroll
    for (int ks = 0; ks < 2; ++ks) Kf[ks] = *(const bf16x8*)(KT + (16 * wid + fr) * 144 + (32 * ks + 8 * fq) * 2);
    float* UT = (float*)(a.ws + WS_UT) + (size_t)un * 16384;
#pragma unroll
    for (int et = 0; et < 8; ++et) { f32x4 acc = (f32x4){0.f, 0.f, 0.f, 0.f};
#pragma unroll
        for (int ks = 0; ks < 2; ++ks) { const bf16x8 Vf = *(const bf16x8*)(VT + (16 * et + fr) * 144 + (32 * ks + 8 * fq) * 2);
            acc = __builtin_amdgcn_mfma_f32_16x16x32_bf16(Kf[ks], Vf, acc, 0, 0, 0); }
        *(f32x4*)(UT + (size_t)(16 * et + fr) * 128 + 16 * wid + 4 * fq) = acc; }
    __syncthreads();
}

__device__ __forceinline__ void hgrn_scan(const Args& a) {
    const float* UT = (const float*)(a.ws + WS_UT); const float* DEC = (const float*)(a.ws + WS_DEC); u16* SP = (u16*)(a.ws + WS_SP);
    for (int gid = blockIdx.x * 512 + threadIdx.x; gid < 8 * 16384; gid += gridDim.x * 512) {
        const int bh = gid >> 14, ed = gid & 16383, d = ed & 127; float S = 0.f;
        for (int n0 = 0; n0 < 128; n0 += 8) { float uv[8], dv[8];
#pragma unroll
            for (int j = 0; j < 8; ++j) { const size_t un = (size_t)bh * 128 + n0 + j; uv[j] = UT[un * 16384 + ed]; dv[j] = DEC[un * 128 + d]; }
#pragma unroll
            for (int j = 0; j < 8; ++j) { const size_t un = (size_t)bh * 128 + n0 + j; SP[un * 16384 + ed] = (u16)(pk2(S, 0.f) & 0xffffu); S = dv[j] * S + uv[j]; } }
    }
}

__device__ __forceinline__ void hgrn_out_unit(const Args& a, unsigned char* lds, int un) {
    const int tid = threadIdx.x, wid = __builtin_amdgcn_readfirstlane(tid >> 6), lane = tid & 63, fr = lane & 15, fq = lane >> 4;
    const int n = un & 127, bh = un >> 7, h = bh & 3, b = bh >> 2, t0 = b * 8192 + n * 64;
    const u16* PROJ = (const u16*)(a.ws + WS_PROJ); u16* MIX = (u16*)(a.ws + WS_MIX);
    float* LF = (float*)lds; float* GT = (float*)(lds + 32768);
    unsigned char* QE = lds + 34816; unsigned char* KE = lds + 52224; unsigned char* QB = lds + 69632; unsigned char* VT = lds + 87040; float* NS = (float*)(lds + 105472);
    hgrn_load_lf_v(PROJ, t0, h, LF, VT, tid);
    __syncthreads();
    { const int d = tid & 127, sg = tid >> 7; float cum[16]; float run = 0.f;
#pragma unroll
      for (int r = 0; r < 16; ++r) { run += LF[(16 * sg + r) * 128 + d]; cum[r] = run; }
      GT[sg * 128 + d] = run;
      __syncthreads();
      float off = 0.f;
#pragma unroll
      for (int q = 0; q < 4; ++q) { const float gq = GT[q * 128 + d]; if (q < sg) off += gq; }
#pragma unroll
      for (int r = 0; r < 16; ++r) LF[(16 * sg + r) * 128 + d] = off + cum[r]; }
    __syncthreads();
#pragma unroll
    for (int i = 0; i < 2; ++i) { const int p = tid + 512 * i, s = p >> 4, d0 = (p & 15) * 8;
        const u32x4 qraw = *(const u32x4*)(PROJ + (size_t)(t0 + s) * DIN + CQ_ + h * 128 + d0);
        float qv[8] = {bflo(qraw.x), bfhi(qraw.x), bflo(qraw.y), bfhi(qraw.y), bflo(qraw.z), bfhi(qraw.z), bflo(qraw.w), bfhi(qraw.w)};
        float qe[8], ke[8], qb[8];
#pragma unroll
        for (int j = 0; j < 8; ++j) { const float bb = LF[s * 128 + d0 + j], bp = s > 0 ? LF[(s - 1) * 128 + d0 + j] : 0.f, rf = LF[31 * 128 + d0 + j];
            const float kk = 1.0f - __expf(bb - bp), e1 = __expf(bb - rf), e2 = __expf(rf - bb);
            qe[j] = qv[j] * e1; ke[j] = kk * e2; qb[j] = qv[j] * __expf(bb); }
        u32x4 w; w.x = pk2(qe[0], qe[1]); w.y = pk2(qe[2], qe[3]); w.z = pk2(qe[4], qe[5]); w.w = pk2(qe[6], qe[7]); *(u32x4*)(QE + s * 272 + d0 * 2) = w;
        w.x = pk2(ke[0], ke[1]); w.y = pk2(ke[2], ke[3]); w.z = pk2(ke[4], ke[5]); w.w = pk2(ke[6], ke[7]); *(u32x4*)(KE + s * 272 + d0 * 2) = w;
        w.x = pk2(qb[0], qb[1]); w.y = pk2(qb[2], qb[3]); w.z = pk2(qb[4], qb[5]); w.w = pk2(qb[6], qb[7]); *(u32x4*)(QB + s * 272 + d0 * 2) = w; }
    __syncthreads();
    const int ct = wid & 3, eh = wid >> 2;
    bf16x8 Bq[4];
#pragma unroll
    for (int ks = 0; ks < 4; ++ks) Bq[ks] = *(const bf16x8*)(QE + (16 * ct + fr) * 272 + (32 * ks + 8 * fq) * 2);
    f32x4 PT[4];
#pragma unroll
    for (int st = 0; st < 4; ++st) { f32x4 acc = (f32x4){0.f, 0.f, 0.f, 0.f};
        if (st <= ct) {
#pragma unroll
            for (int ks = 0; ks < 4; ++ks) { const bf16x8 Ak = *(const bf16x8*)(KE + (16 * st + fr) * 272 + (32 * ks + 8 * fq) * 2);
                acc = __builtin_amdgcn_mfma_f32_16x16x32_bf16(Ak, Bq[ks], acc, 0, 0, 0); }
#pragma unroll
            for (int r = 0; r < 4; ++r) if (16 * st + 4 * fq + r > 16 * ct + fr) acc[r] = 0.f; }
        PT[st] = acc; }
    bf16x8 Pb[2];
#pragma unroll
    for (int kk = 0; kk < 2; ++kk) { u32x4 p; p.x = pk2(PT[2 * kk][0], PT[2 * kk][1]); p.y = pk2(PT[2 * kk][2], PT[2 * kk][3]); p.z = pk2(PT[2 * kk + 1][0], PT[2 * kk + 1][1]); p.w = pk2(PT[2 * kk + 1][2], PT[2 * kk + 1][3]);
        Pb[kk] = __builtin_bit_cast(bf16x8, p); }
#pragma unroll
    for (int ks = 0; ks < 4; ++ks) Bq[ks] = *(const bf16x8*)(QB + (16 * ct + fr) * 272 + (32 * ks + 8 * fq) * 2);
    const u16* SP = (const u16*)(a.ws + WS_SP) + (size_t)un * 16384;
    f32x4 OT[4]; float ssq = 0.f;
#pragma unroll
    for (int e4 = 0; e4 < 4; ++e4) { const int et = 4 * eh + e4; f32x4 acc = (f32x4){0.f, 0.f, 0.f, 0.f};
#pragma unroll
        for (int kk = 0; kk < 2; ++kk) { const u32x2 lo = *(const u32x2*)(VT + (16 * et + fr) * 144 + (32 * kk + 4 * fq) * 2), hi = *(const u32x2*)(VT + (16 * et + fr) * 144 + (32 * kk + 16 + 4 * fq) * 2);
            u32x4 av; av.x = lo.x; av.y = lo.y; av.z = hi.x; av.w = hi.y;
            acc = __builtin_amdgcn_mfma_f32_16x16x32_bf16(__builtin_bit_cast(bf16x8, av), Pb[kk], acc, 0, 0, 0); }
#pragma unroll
        for (int ks = 0; ks < 4; ++ks) { const bf16x8 As = *(const bf16x8*)(SP + (size_t)(16 * et + fr) * 128 + 32 * ks + 8 * fq);
            acc = __builtin_amdgcn_mfma_f32_16x16x32_bf16(As, Bq[ks], acc, 0, 0, 0); }
        OT[e4] = acc; ssq += (acc[0] * acc[0] + acc[1] * acc[1]) + (acc[2] * acc[2] + acc[3] * acc[3]); }
    ssq += __shfl_xor(ssq, 16); ssq += __shfl_xor(ssq, 32);
    if (fq == 0) NS[eh * 64 + 16 * ct + fr] = ssq;
    __syncthreads();
    const float rstd = 1.0f / sqrtf((NS[16 * ct + fr] + NS[64 + 16 * ct + fr]) * (1.f / 128.f) + EPS);
    const int c = 16 * ct + fr;
#pragma unroll
    for (int e4 = 0; e4 < 4; ++e4) { const int e0 = 16 * (4 * eh + e4) + 4 * fq;
        const f32x4 og = *(const f32x4*)(a.in[I_OG] + h * 128 + e0); const u32x2 gg = *(const u32x2*)(PROJ + (size_t)(t0 + c) * DIN + CG_ + h * 128 + e0);
        const float o0 = OT[e4][0] * rstd * og[0] * bflo(gg.x), o1 = OT[e4][1] * rstd * og[1] * bfhi(gg.x), o2 = OT[e4][2] * rstd * og[2] * bflo(gg.y), o3 = OT[e4][3] * rstd * og[3] * bfhi(gg.y);
        u32x2 w; w.x = pk2(o0, o1); w.y = pk2(o2, o3); *(u32x2*)(MIX + (size_t)(t0 + c) * D + 512 + h * 128 + e0) = w; }
    __syncthreads();
}

__device__ __forceinline__ void router_unit(const Args& a, unsigned char* lds, int ug) {
    const int tid = threadIdx.x, wid = __builtin_amdgcn_readfirstlane(tid >> 6), lane = tid & 63, fr = lane & 15, fq = lane >> 4;
    const u16* HB = (const u16*)(a.ws + WS_HB); const u16* WRT = (const u16*)(a.ws + WS_WRT);
    float* X2 = (float*)lds;
    float* LG = (float*)(lds + 13312);
    float* SSL = (float*)(lds + 25856);
    int* EIDL = (int*)(lds + 26112);
    const int rt = wid & 3, kh = wid >> 2, row = ug * 64 + 16 * rt + fr;
    f32x4 acc[3]; acc[0] = acc[1] = acc[2] = (f32x4){0.f, 0.f, 0.f, 0.f}; float ss = 0.f;
    for (int ks = 0; ks < 16; ++ks) { const int k = 512 * kh + 32 * ks + 8 * fq;
        const u32x4 av = *(const u32x4*)(HB + (size_t)row * D + k);
#pragma unroll
        for (int w = 0; w < 4; ++w) { const float lo = bflo(av[w]), hi = bfhi(av[w]); ss += lo * lo + hi * hi; }
#pragma unroll
        for (int nt = 0; nt < 3; ++nt) { const bf16x8 Bf = *(const bf16x8*)(WRT + (size_t)(16 * nt + fr) * D + k);
            acc[nt] = __builtin_amdgcn_mfma_f32_16x16x32_bf16(__builtin_bit_cast(bf16x8, av), Bf, acc[nt], 0, 0, 0); } }
    ss += __shfl_xor(ss, 16); ss += __shfl_xor(ss, 32);
    if (kh == 1) { float* p = X2 + (rt * 64 + lane) * 13;
#pragma unroll
        for (int nt = 0; nt < 3; ++nt)
#pragma unroll
            for (int r = 0; r < 4; ++r) p[nt * 4 + r] = acc[nt][r];
        p[12] = ss; }
    __syncthreads();
    if (kh == 0) { const float* p = X2 + (rt * 64 + lane) * 13;
#pragma unroll
        for (int nt = 0; nt < 3; ++nt)
#pragma unroll
            for (int r = 0; r < 4; ++r) LG[(16 * rt + 4 * fq + r) * 49 + 16 * nt + fr] = acc[nt][r] + p[nt * 4 + r];
        if (fq == 0) SSL[16 * rt + fr] = ss + p[12]; }
    __syncthreads();
    if (tid < 64) { const int t = ug * 64 + tid; const float* lg = LG + tid * 49;
        const float rstd = 1.0f / sqrtf(SSL[tid] * (1.f / D) + EPS);
        float gl[4]; int gi = 0; float gm = -3.0e38f;
#pragma unroll
        for (int j = 0; j < 4; ++j) { gl[j] = lg[32 + j] * rstd + a.in[I_BGR][j]; if (gl[j] > gm) { gm = gl[j]; gi = j; } }
        float den = 0.f;
#pragma unroll
        for (int j = 0; j < 4; ++j) den += expf(gl[j] - gm);
        const float gprob = 1.0f / den;
        float v0 = -3.0e38f, v1 = -3.0e38f; int i0 = 0, i1 = 0;
        for (int j = 0; j < 8; ++j) { const float v = lg[8 * gi + j] * rstd + a.in[I_BER][8 * gi + j];
            if (v > v0) { v1 = v0; i1 = i0; v0 = v; i0 = j; } else if (v > v1) { v1 = v; i1 = j; } }
        const float w0 = 1.0f / (1.0f + expf(v1 - v0)), w1 = 1.0f - w0;
        const int e0 = 8 * gi + i0, e1 = 8 * gi + i1;
        ((float*)(a.ws + WS_RSTD2))[t] = rstd;
        int* RTE = (int*)(a.ws + WS_RTE); float* RTW = (float*)(a.ws + WS_RTW);
        RTE[2 * t] = e0; RTE[2 * t + 1] = e1; RTW[2 * t] = gprob * w0; RTW[2 * t + 1] = gprob * w1;
        EIDL[2 * tid] = e0; EIDL[2 * tid + 1] = e1; }
    __syncthreads();
    if (tid < 128) { const int me = EIDL[tid]; int rk = 0; for (int j = 0; j < tid; ++j) rk += (EIDL[j] == me) ? 1 : 0; ((int*)(a.ws + WS_RTR))[ug * 128 + tid] = rk; }
    else if (tid < 160) { const int e = tid - 128; int c = 0; for (int j = 0; j < 128; ++j) c += (EIDL[j] == e) ? 1 : 0; ((int*)(a.ws + WS_CNT))[ug * 32 + e] = c; }
    __syncthreads();
}
__device__ __forceinline__ void moe_weight_convert(const Args& a, unsigned char* lds) {
    const int tid = threadIdx.x, lane = tid & 63, wave = tid >> 6;
    float* scr = (float*)(lds + 32768 + wave * 8704);
    const int gw = blockIdx.x * 8 + wave, NGW = gridDim.x * 8;
    u16* WGU = (u16*)(a.ws + WS_WGU); u16* WD = (u16*)(a.ws + WS_WD);
    constexpr int PER_E = 256, N_GU = NE * 2 * PER_E, N_D = NE * PER_E;
    for (int it = gw; it < N_GU + N_D; it += NGW) {
        if (it < N_GU) { const int e = it / (2 * PER_E), r = it % (2 * PER_E), up = r / PER_E, q = r % PER_E, kb = q / 16, nb = q % 16, n0 = 32 * nb;
            tr_item((up ? a.in[I_WU] : a.in[I_WG]) + (size_t)e * D * DE, DE, 64 * kb, n0, a.in[I_G2], WGU + (size_t)e * 1024 * 1024, D, 256 * (n0 >> 7) + (n0 & 127) + 128 * up, scr, lane); }
        else { const int r2 = it - N_GU, e = r2 / PER_E, q = r2 % PER_E, kb = q / 32, nb = q % 32;
            tr_item(a.in[I_WDN] + (size_t)e * DE * D, D, 64 * kb, 32 * nb, nullptr, WD + (size_t)e * 1024 * 512, DE, 32 * nb, scr, lane); }
    }
}

__device__ __forceinline__ void scatter_unit(const Args& a, unsigned char* lds, int ug) {
    const int tid = threadIdx.x;
    int* PART = (int*)lds; int* PARTB = PART + 512; int* TOT = PARTB + 512; int* BASE = TOT + 32; int* PST = BASE + 32;
    const int* CNT = (const int*)(a.ws + WS_CNT);
    { const int e = tid & 31, part = tid >> 5; int s = 0, sb = 0;
#pragma unroll
      for (int j = 0; j < 16; ++j) { const int g = 16 * part + j; const int c = CNT[g * 32 + e]; s += c; if (g < ug) sb += c; }
      PART[part * 32 + e] = s; PARTB[part * 32 + e] = sb; }
    __syncthreads();
    if (tid < 32) { int s = 0, sb = 0; for (int p = 0; p < 16; ++p) { s += PART[p * 32 + tid]; sb += PARTB[p * 32 + tid]; } TOT[tid] = s; BASE[tid] = sb; }
    __syncthreads();
    if (tid == 0) { int run = 0; for (int e = 0; e < 32; ++e) { PST[e] = run; run += (TOT[e] + 255) & ~255; } PST[32] = run; }
    __syncthreads();
    if (tid < 128) { const int t = ug * 64 + (tid >> 1); const int e = ((const int*)(a.ws + WS_RTE))[2 * t + (tid & 1)];
        const int pos = PST[e] + BASE[e] + ((const int*)(a.ws + WS_RTR))[ug * 128 + tid];
        ((int*)(a.ws + WS_ROWTOK))[pos] = 2 * t + (tid & 1); ((float*)(a.ws + WS_ROWWT))[pos] = ((const float*)(a.ws + WS_RTW))[2 * t + (tid & 1)]; }
    if (ug == 0) { int* META = (int*)(a.ws + WS_META); const int nt = PST[32] >> 8; if (tid == 0) META[0] = nt;
        if (tid < nt) { int e = 0; for (int j = 0; j < 32; ++j) if (PST[j] <= 256 * tid) e = j; int nv = TOT[e] - (256 * tid - PST[e]); nv = nv > 256 ? 256 : nv; META[64 + 2 * tid] = e; META[64 + 2 * tid + 1] = nv; } }
    __syncthreads();
}

__device__ __forceinline__ void moe_gu_phase(const Args& a, unsigned char* lds) {
    const int tid = threadIdx.x; const int* META = (const int*)(a.ws + WS_META); const int nt = META[0];
    const int* rowtok = (const int*)(a.ws + WS_ROWTOK); const u16* HB = (const u16*)(a.ws + WS_HB); const u16* WGU = (const u16*)(a.ws + WS_WGU);
    EpiGU E{(u16*)(a.ws + WS_HID), rowtok, (const float*)(a.ws + WS_RSTD2)};
    for (int u = blockIdx.x; u < nt * 4; u += gridDim.x) { MUnit mu; mu.ti = u >> 2; mu.pn = u & 3; mu.e = META[64 + 2 * mu.ti]; mu.nv = META[64 + 2 * mu.ti + 1];
        const u16* ap[4]; const u16* bp[4];
#pragma unroll
        for (int j = 0; j < 4; ++j) { const int r = (tid >> 3) + 64 * j; const int rb = (r & ~31) + perm32(r & 31);
            const int tk = r < mu.nv ? rowtok[mu.ti * 256 + r] : 0;
            ap[j] = HB + (size_t)(tk >> 1) * D + (tid & 7) * 8; bp[j] = WGU + ((size_t)mu.e * 1024 + mu.pn * 256 + rb) * D + (tid & 7) * 8; }
        sg_unit(lds, ap, bp, D, E, mu); }
}
__device__ __forceinline__ void moe_down_phase(const Args& a, unsigned char* lds) {
    const int tid = threadIdx.x; const int* META = (const int*)(a.ws + WS_META); const int nt = META[0];
    const u16* HID = (const u16*)(a.ws + WS_HID); const u16* WD = (const u16*)(a.ws + WS_WD);
    EpiDown E{(u16*)(a.ws + WS_Y0), (long)((WS_Y1 - WS_Y0) / 2), (const int*)(a.ws + WS_ROWTOK), (const float*)(a.ws + WS_ROWWT)};
    for (int u = blockIdx.x; u < nt * 4; u += gridDim.x) { MUnit mu; mu.ti = u >> 2; mu.pn = u & 3; mu.e = META[64 + 2 * mu.ti]; mu.nv = META[64 + 2 * mu.ti + 1];
        const u16* ap[4]; const u16* bp[4];
#pragma unroll
        for (int j = 0; j < 4; ++j) { const int r = (tid >> 3) + 64 * j; const int rb = (r & ~31) + perm32(r & 31);
            ap[j] = HID + (size_t)(mu.ti * 256 + r) * DE + (tid & 7) * 8; bp[j] = WD + ((size_t)mu.e * 1024 + mu.pn * 256 + rb) * DE + (tid & 7) * 8; }
        sg_unit(lds, ap, bp, DE, E, mu); }
}

__device__ __forceinline__ void final_phase(const Args& a) {
    const int tid = threadIdx.x, lane = tid & 63, wave = tid >> 6; const int gw = blockIdx.x * 8 + wave, NGW = gridDim.x * 8;
    const u16* Y0 = (const u16*)(a.ws + WS_Y0); const u16* Y1 = (const u16*)(a.ws + WS_Y1); const float* fg = a.in[I_FG];
    for (int m = gw; m < T; m += NGW) {
        f32x4* hr = (f32x4*)(a.out + (size_t)m * D) + lane; const u32x2* y0 = (const u32x2*)(Y0 + (size_t)m * D) + lane; const u32x2* y1 = (const u32x2*)(Y1 + (size_t)m * D) + lane;
        f32x4 v[4]; float s = 0.f;
#pragma unroll
        for (int j = 0; j < 4; ++j) { v[j] = hr[64 * j]; const u32x2 p = y0[64 * j], q = y1[64 * j];
            v[j].x += bflo(p.x) + bflo(q.x); v[j].y += bfhi(p.x) + bfhi(q.x); v[j].z += bflo(p.y) + bflo(q.y); v[j].w += bfhi(p.y) + bfhi(q.y);
            s += (v[j].x * v[j].x + v[j].y * v[j].y) + (v[j].z * v[j].z + v[j].w * v[j].w); }
        const float rstd = 1.0f / sqrtf(wave_sum(s) * (1.f / D) + EPS);
#pragma unroll
        for (int j = 0; j < 4; ++j) { const f32x4 g = ((const f32x4*)fg)[lane + 64 * j]; hr[64 * j] = v[j] * rstd * g; }
    }
}

__global__ void __launch_bounds__(512, 2) fwd(Args a) {
    extern __shared__ __attribute__((aligned(16))) unsigned char lds[];
    const int tid = threadIdx.x;
    volatile LAS unsigned* MISC = (volatile LAS unsigned*)((LAS unsigned char*)lds + (LDS_BYTES - 64));
    if (tid < 16) MISC[tid] = 0u;
    __syncthreads();
    const int lo = a.ph_lo, hi = a.ph_hi;
    XcdBarrier bar; bar.bar = (unsigned*)(a.ws + WS_CTL) + 4096; bar.x = 0; bar.st = nullptr;
    if (hi - lo > 1) bar = xcd_barrier_post((unsigned*)(a.ws + WS_CTL) + 4096, MISC);
#define IN(k) (lo <= (k) && (k) < hi)
#define SEAM(k) do { if (IN(k) && IN((k) + 1)) xcd_barrier(bar); } while (0)
    const int G = gridDim.x, bx = blockIdx.x;
    if (IN(0)) { p0_prologue(a, lds); } SEAM(0);
    if (IN(1)) { EpiProj E{(u16*)(a.ws + WS_PROJ), (const float*)(a.ws + WS_LB)};
        dense_gemm_phase(lds, (const u16*)(a.ws + WS_XB), (const u16*)(a.ws + WS_WIN), T, DIN, D, E); } SEAM(1);
    if (IN(2)) { for (int u = bx; u < 512 + 1024; u += G) { if (u < 1024) hgrn_local_unit(a, lds, u); else gmlp_unit(a, lds, u - 1024); } } SEAM(2);
    if (IN(3)) { hgrn_scan(a); } SEAM(3);
    if (IN(4)) { for (int u = bx; u < 1024; u += G) hgrn_out_unit(a, lds, u); } SEAM(4);
    if (IN(5)) { EpiRes E{a.in[I_X], a.out, (u16*)(a.ws + WS_HB)};
        dense_gemm_phase(lds, (const u16*)(a.ws + WS_MIX), (const u16*)(a.ws + WS_WOUT), T, D, D, E); } SEAM(5);
    if (IN(6)) { for (int u = bx; u < 256; u += G) router_unit(a, lds, u); moe_weight_convert(a, lds); } SEAM(6);
    if (IN(7)) { for (int u = bx; u < 256; u += G) scatter_unit(a, lds, u); } SEAM(7);
    if (IN(8)) { moe_gu_phase(a, lds); } SEAM(8);
    if (IN(9)) { moe_down_phase(a, lds); } SEAM(9);
    if (IN(10)) { final_phase(a); }
#undef IN
#undef SEAM
}

extern "C" void kernel_launch(void* const* d_in, const int* in_sizes, int n_in, void* d_out, int out_size, void* d_ws, size_t ws_size, hipStream_t stream) {
    static int grid = 0;
    if (grid == 0) {
        if (n_in != 18 || out_size != T * D || ws_size < WS_END) { fprintf(stderr, "kernel_launch: unexpected shapes (n_in %d out %d ws %zu)\n", n_in, out_size, ws_size); grid = -1; return; }
        int dev = 0, cus = 0, per_cu = 0;
        (void)hipGetDevice(&dev); (void)hipDeviceGetAttribute(&cus, hipDeviceAttributeMultiprocessorCount, dev);
        (void)hipFuncSetAttribute((const void*)fwd, hipFuncAttributeMaxDynamicSharedMemorySize, LDS_BYTES);
        (void)hipOccupancyMaxActiveBlocksPerMultiprocessor(&per_cu, (const void*)fwd, 512, LDS_BYTES);
        (void)hipGetLastError();
        if (per_cu < 1) fprintf(stderr, "kernel_launch: occupancy query says %d blocks per CU\n", per_cu);
        grid = cus;
    }
    if (grid < 0) return;
    (void)hipMemsetAsync((char*)d_ws + WS_CTL, 0, CTL_BYTES, stream);
    Args a{};
    for (int i = 0; i < 18; ++i) a.in[i] = (const float*)d_in[i];
    a.out = (float*)d_out; a.ws = (unsigned char*)d_ws;
#if MK_ONE
    a.ph_lo = 0; a.ph_hi = NPH;
    hipLaunchKernelGGL(fwd, dim3(grid), dim3(512), LDS_BYTES, stream, a);
#else
    for (int p = 0; p < NPH; ++p) { a.ph_lo = p; a.ph_hi = p + 1; hipLaunchKernelGGL(fwd, dim3(grid), dim3(512), LDS_BYTES, stream, a); }
#endif
}
```
